# Optimizing an MI355X kernel written in HIP

```python
import jax, jax.numpy as jnp
from jax import lax
import numpy as np

D_MODEL = 1024
BATCH = 2
SEQ = 8192
DEPTH = 1

CHUNK = 64
Q_BLOCK = 128
EPS = 1e-6
D_FF = 2816
N_MOD = 9
CONV_WIDTH = 512
CONV_GROUPS = 8
CONV_K = 3
MLA_HEADS = 4
QK_NOPE = 128
QK_ROPE = 64
V_HEAD = 128
Q_LORA = 384
KV_LORA = 256
ROPE_THETA = 10000.0
MLA_WIDTH = MLA_HEADS * V_HEAD
MIX_WIDTH = CONV_WIDTH + MLA_WIDTH
IN_COLS = 3 * CONV_WIDTH + Q_LORA + KV_LORA + QK_ROPE

kernel_name = "hymba_conv_mla_macaron_adaln_block"


def rmsnorm(x, g):
    xf = x.astype(jnp.float32)
    y = xf * lax.rsqrt(jnp.mean(xf * xf, axis=-1, keepdims=True) + EPS)
    return (y * g.astype(jnp.float32)).astype(x.dtype)


def group_rmsnorm(y, g, n_groups):
    b, s, w = y.shape
    yf = y.astype(jnp.float32).reshape(b, s, n_groups, w // n_groups)
    yf = yf * lax.rsqrt(jnp.mean(yf * yf, axis=-1, keepdims=True) + EPS)
    return (yf.reshape(b, s, w) * g.astype(jnp.float32)).astype(y.dtype)


def modulate(h, shift, scale):
    return h * (1.0 + scale[:, None, :]) + shift[:, None, :]


def swiglu(h, w1, w3, w2):
    return (jax.nn.silu(h @ w1) * (h @ w3)) @ w2


def rope(x, cos, sin):
    half = x.shape[-1] // 2
    x1, x2 = x[..., :half], x[..., half:]
    return jnp.concatenate([x1 * cos - x2 * sin, x1 * sin + x2 * cos], axis=-1)


def short_conv_mixer(xb, xc, xu, conv_w):
    u = xc * xu
    s = u.shape[1]
    up = jnp.pad(u, ((0, 0), (CONV_K - 1, 0), (0, 0)))
    y = conv_w[0] * up[:, 0:s]
    for k in range(1, CONV_K):
        y = y + conv_w[k] * up[:, k:k + s]
    return xb * y


def mla(cq, ckv, kr, positions, q_norm_g, w_uq, kv_norm_g, w_ukv):
    b, s, _ = cq.shape
    q = (rmsnorm(cq, q_norm_g) @ w_uq).reshape(b, s, MLA_HEADS, QK_NOPE + QK_ROPE)
    q_nope, q_rope = q[..., :QK_NOPE], q[..., QK_NOPE:]
    kv = (rmsnorm(ckv, kv_norm_g) @ w_ukv).reshape(b, s, MLA_HEADS, QK_NOPE + V_HEAD)
    k_nope, v = kv[..., :QK_NOPE], kv[..., QK_NOPE:]

    inv_freq = ROPE_THETA ** (-jnp.arange(0, QK_ROPE, 2, dtype=jnp.float32) / QK_ROPE)
    ang = positions.astype(jnp.float32)[..., None] * inv_freq
    cos = jnp.cos(ang).astype(cq.dtype)
    sin = jnp.sin(ang).astype(cq.dtype)
    q_rope = rope(q_rope, cos[:, :, None, :], sin[:, :, None, :])
    k_rope = rope(kr, cos, sin)

    scale = (QK_NOPE + QK_ROPE) ** -0.5
    nblk = s // Q_BLOCK
    qn_b = q_nope.reshape(b, nblk, Q_BLOCK, MLA_HEADS, QK_NOPE).transpose(1, 0, 2, 3, 4)
    qr_b = q_rope.reshape(b, nblk, Q_BLOCK, MLA_HEADS, QK_ROPE).transpose(1, 0, 2, 3, 4)
    k_chunk = jnp.arange(s) // CHUNK

    def block(args):
        i, qn, qr = args
        sc = (jnp.einsum('bqhd,bkhd->bhqk', qn, k_nope)
              + jnp.einsum('bqhd,bkd->bhqk', qr, k_rope)).astype(jnp.float32) * scale
        q_chunk = (i * Q_BLOCK + jnp.arange(Q_BLOCK)) // CHUNK
        mask = k_chunk[None, :] <= q_chunk[:, None]
        sc = jnp.where(mask[None, None], sc, jnp.float32(-1e30))
        p = jax.nn.softmax(sc, axis=-1).astype(v.dtype)
        return jnp.einsum('bhqk,bkhd->bqhd', p, v)

    o = lax.map(block, (jnp.arange(nblk), qn_b, qr_b))
    return o.transpose(1, 0, 2, 3, 4).reshape(b, s, MLA_WIDTH)


def setup_inputs(seed: int = 0) -> dict:
    key = jax.random.key(seed)
    ks = iter(jax.random.split(key, 32))
    f32 = jnp.float32
    L = DEPTH

    def nrm(shape, fan_in, scale=1.0):
        return jax.random.normal(next(ks), shape, f32) * (scale * fan_in ** -0.5)

    def gain(shape):
        return 1.0 + 0.05 * jax.random.normal(next(ks), shape, f32)

    x = jax.random.normal(next(ks), (BATCH, SEQ, D_MODEL), f32)
    c = jax.random.normal(next(ks), (BATCH, D_MODEL), f32)
    offset = jax.random.randint(next(ks), (BATCH, 1), 0, 4096)
    positions = (offset + jnp.arange(SEQ)[None, :]).astype(jnp.int32)
    return {
        "x": x,
        "c": c,
        "positions": positions,
        "ada_w": nrm((L, D_MODEL, N_MOD * D_MODEL), D_MODEL, 0.5),
        "ada_b": 0.02 * jax.random.normal(next(ks), (L, N_MOD * D_MODEL), f32),
        "norm_ffn1_g": gain((L, D_MODEL)),
        "ffn1_w1": nrm((L, D_MODEL, D_FF), D_MODEL),
        "ffn1_w3": nrm((L, D_MODEL, D_FF), D_MODEL),
        "ffn1_w2": nrm((L, D_FF, D_MODEL), D_FF),
        "norm_mix_g": gain((L, D_MODEL)),
        "w_in": nrm((L, D_MODEL, IN_COLS), D_MODEL),
        "conv_w": nrm((L, CONV_K, CONV_WIDTH), CONV_K),
        "q_norm_g": gain((L, Q_LORA)),
        "w_uq": nrm((L, Q_LORA, MLA_HEADS * (QK_NOPE + QK_ROPE)), Q_LORA),
        "kv_norm_g": gain((L, KV_LORA)),
        "w_ukv": nrm((L, KV_LORA, MLA_HEADS * (QK_NOPE + V_HEAD)), KV_LORA),
        "out_norm_g": gain((L, MIX_WIDTH)),
        "w_out": nrm((L, MIX_WIDTH, D_MODEL), MIX_WIDTH),
        "norm_ffn2_g": gain((L, D_MODEL)),
        "ffn2_w1": nrm((L, D_MODEL, D_FF), D_MODEL),
        "ffn2_w3": nrm((L, D_MODEL, D_FF), D_MODEL),
        "ffn2_w2": nrm((L, D_FF, D_MODEL), D_FF),
        "final_norm_g": gain((D_MODEL,)),
    }


def reference(x, c, positions, ada_w, ada_b, norm_ffn1_g, ffn1_w1, ffn1_w3, ffn1_w2,
              norm_mix_g, w_in, conv_w, q_norm_g, w_uq, kv_norm_g, w_ukv, out_norm_g,
              w_out, norm_ffn2_g, ffn2_w1, ffn2_w3, ffn2_w2, final_norm_g):
    b = x.shape[0]
    cuts = [CONV_WIDTH, 2 * CONV_WIDTH, 3 * CONV_WIDTH,
            3 * CONV_WIDTH + Q_LORA, 3 * CONV_WIDTH + Q_LORA + KV_LORA]
    for l in range(DEPTH):
        mod = (jax.nn.silu(c) @ ada_w[l] + ada_b[l]).reshape(b, N_MOD, D_MODEL)
        sh1, sc1, g1 = mod[:, 0], mod[:, 1], mod[:, 2]
        sh2, sc2, g2 = mod[:, 3], mod[:, 4], mod[:, 5]
        sh3, sc3, g3 = mod[:, 6], mod[:, 7], mod[:, 8]

        h = modulate(rmsnorm(x, norm_ffn1_g[l]), sh1, sc1)
        x = x + 0.5 * g1[:, None, :] * swiglu(h, ffn1_w1[l], ffn1_w3[l], ffn1_w2[l])

        h = modulate(rmsnorm(x, norm_mix_g[l]), sh2, sc2)
        z = h @ w_in[l]
        xb, xc, xu, cq, ckv, kr = jnp.split(z, cuts, axis=-1)
        y_a = short_conv_mixer(xb, xc, xu, conv_w[l])
        y_b = mla(cq, ckv, kr, positions, q_norm_g[l], w_uq[l], kv_norm_g[l], w_ukv[l])
        y_a = group_rmsnorm(y_a, out_norm_g[l, :CONV_WIDTH], CONV_GROUPS)
        y_b = group_rmsnorm(y_b, out_norm_g[l, CONV_WIDTH:], MLA_HEADS)
        y = jnp.concatenate([y_a, y_b], axis=-1) @ w_out[l]
        x = x + g2[:, None, :] * y

        h = modulate(rmsnorm(x, norm_ffn2_g[l]), sh3, sc3)
        x = x + 0.5 * g3[:, None, :] * swiglu(h, ffn2_w1[l], ffn2_w3[l], ffn2_w2[l])
    return rmsnorm(x, final_norm_g)
```

```cpp
#include <hip/hip_runtime.h>
#include <cstdio>
#include <cstdint>

namespace nv {
constexpr int B = 2, S = 8192, D = 1024, FF = 2816, NMOD = 9;
constexpr int CW = 512, CG = 8, CK = 3, H = 4, NOPE = 128, ROPE = 64, VH = 128, QL = 384, KVL = 256;
constexpr int INC = 3 * CW + QL + KVL + ROPE;
constexpr int QW = H * (NOPE + ROPE);
constexpr int KVW = H * (NOPE + VH);
constexpr float EPS = 1e-6f;

__device__ __forceinline__ float silu_f(float v) { return v / (1.f + __expf(-v)); }

__global__ void k_mod(const float* __restrict__ c, const float* __restrict__ w, const float* __restrict__ bias, float* __restrict__ mod) {
    const int j = blockIdx.x * blockDim.x + threadIdx.x, b = blockIdx.y;
    if (j >= NMOD * D) return;
    float acc = 0.f;
    for (int k = 0; k < D; ++k) acc += silu_f(c[b * D + k]) * w[(size_t)k * (NMOD * D) + j];
    mod[b * NMOD * D + j] = acc + bias[j];
}

__global__ void k_copy_rows(const float* __restrict__ x, float* __restrict__ xc, const int* __restrict__ pos, int* __restrict__ posc, int Se) {
    const int r = blockIdx.x, b = r / Se, t = r % Se;
    const float4* src = (const float4*)(x + ((size_t)b * S + t) * D);
    float4* dst = (float4*)(xc + (size_t)r * D);
    dst[threadIdx.x] = src[threadIdx.x];
    if (threadIdx.x == 0) posc[r] = pos[b * S + t];
}

__device__ __forceinline__ float block_sum(float v, float* red) {
    for (int o = 32; o > 0; o >>= 1) v += __shfl_xor(v, o);
    const int w = threadIdx.x >> 6, nw = blockDim.x >> 6;
    __syncthreads();
    if ((threadIdx.x & 63) == 0) red[w] = v;
    __syncthreads();
    float s = 0.f;
    for (int i = 0; i < nw; ++i) s += red[i];
    return s;
}

__global__ void k_rmsnorm_rows(const float* in, int ldi, float* out, int ldo, const float* __restrict__ g, int L,
                               const float* __restrict__ mod, int sh_idx, int sc_idx, int rows_per_batch) {
    __shared__ float red[8];
    const int r = blockIdx.x, b = r / rows_per_batch;
    const float* xr = in + (size_t)r * ldi;
    float v[4]; float ss = 0.f;
    for (int i = 0; i < 4; ++i) { const int c = threadIdx.x + i * 256; v[i] = c < L ? xr[c] : 0.f; ss += v[i] * v[i]; }
    const float tot = block_sum(ss, red);
    const float rstd = rsqrtf(tot / (float)L + EPS);
    for (int i = 0; i < 4; ++i) { const int c = threadIdx.x + i * 256; if (c < L) {
        float y = v[i] * rstd * g[c];
        if (sh_idx >= 0) y = y * (1.f + mod[(b * NMOD + sc_idx) * D + c]) + mod[(b * NMOD + sh_idx) * D + c];
        out[(size_t)r * ldo + c] = y; } }
}

template <int MODE>
__global__ void __launch_bounds__(256) k_gemm(const float* __restrict__ A, int lda, const float* __restrict__ W, const float* __restrict__ W2, int ldw,
                                              float* C, int ldc, int K, const float* R, int ldr, const float* __restrict__ gate, int rows_per_batch, float gscale) {
    __shared__ float As[16][64 + 4];
    __shared__ float Ws[16][64 + 4];
    __shared__ float Vs[MODE == 1 ? 16 : 1][64 + 4];
    const int tid = threadIdx.x, tx = tid & 15, ty = tid >> 4;
    const int row0 = blockIdx.y * 64, col0 = blockIdx.x * 64;
    float acc[4][4] = {}, acc2[4][4] = {};
    for (int k0 = 0; k0 < K; k0 += 16) {
        { const int r = tid >> 2, kk = (tid & 3) * 4; const float4 a = *(const float4*)(A + (size_t)(row0 + r) * lda + k0 + kk);
          As[kk + 0][r] = a.x; As[kk + 1][r] = a.y; As[kk + 2][r] = a.z; As[kk + 3][r] = a.w; }
        { const int kk = tid >> 4, cc = (tid & 15) * 4; const float4 w = *(const float4*)(W + (size_t)(k0 + kk) * ldw + col0 + cc);
          Ws[kk][cc + 0] = w.x; Ws[kk][cc + 1] = w.y; Ws[kk][cc + 2] = w.z; Ws[kk][cc + 3] = w.w;
          if (MODE == 1) { const float4 w2 = *(const float4*)(W2 + (size_t)(k0 + kk) * ldw + col0 + cc);
              Vs[kk][cc + 0] = w2.x; Vs[kk][cc + 1] = w2.y; Vs[kk][cc + 2] = w2.z; Vs[kk][cc + 3] = w2.w; } }
        __syncthreads();
#pragma unroll
        for (int k = 0; k < 16; ++k) {
            float a[4], b[4], b2[4];
#pragma unroll
            for (int i = 0; i < 4; ++i) { a[i] = As[k][ty * 4 + i]; b[i] = Ws[k][tx * 4 + i]; if (MODE == 1) b2[i] = Vs[k][tx * 4 + i]; }
#pragma unroll
            for (int i = 0; i < 4; ++i)
#pragma unroll
                for (int j = 0; j < 4; ++j) { acc[i][j] += a[i] * b[j]; if (MODE == 1) acc2[i][j] += a[i] * b2[j]; }
        }
        __syncthreads();
    }
#pragma unroll
    for (int i = 0; i < 4; ++i) { const int r = row0 + ty * 4 + i;
#pragma unroll
        for (int j = 0; j < 4; ++j) { const int c = col0 + tx * 4 + j; float v = acc[i][j];
            if (MODE == 1) v = silu_f(acc[i][j]) * acc2[i][j];
            if (MODE == 2) { const int b = r / rows_per_batch; v = R[(size_t)r * ldr + c] + gscale * gate[(size_t)b * NMOD * D + c] * v; }
            C[(size_t)r * ldc + c] = v; } }
}

__global__ void k_conv(const float* __restrict__ z, const float* __restrict__ cw, float* __restrict__ ya, int Se) {
    const int r = blockIdx.x, t = r % Se;
    for (int ch = threadIdx.x; ch < CW; ch += blockDim.x) {
        float y = 0.f;
        for (int k = 0; k < CK; ++k) { const int dt = CK - 1 - k; if (t - dt >= 0) { const float* zr = z + (size_t)(r - dt) * (3 * CW); y += cw[k * CW + ch] * (zr[CW + ch] * zr[2 * CW + ch]); } }
        ya[(size_t)r * CW + ch] = z[(size_t)r * (3 * CW) + ch] * y;
    }
}

__global__ void k_rope(float* q, float* kr, const int* __restrict__ pos) {
    const int r = blockIdx.x;
    const float p = (float)pos[r];
    for (int idx = threadIdx.x; idx < (H + 1) * 32; idx += blockDim.x) {
        const int hh = idx / 32, i = idx % 32;
        const double inv = pow(10000.0, -(double)(2 * i) / 64.0);
        const float ang = p * (float)inv;
        const float cs = (float)cos((double)ang), sn = (float)sin((double)ang);
        float* base = hh < H ? q + (size_t)r * QW + hh * (NOPE + ROPE) + NOPE : kr + (size_t)r * ROPE;
        const float x1 = base[i], x2 = base[i + 32];
        base[i] = x1 * cs - x2 * sn; base[i + 32] = x1 * sn + x2 * cs;
    }
}

__global__ void __launch_bounds__(256) k_attn(const float* __restrict__ q, const float* __restrict__ kv, const float* __restrict__ kr, float* __restrict__ yb, int Se) {
    extern __shared__ float sm[];
    float* sc = sm; float* qs = sm + 2 * Se; float* red = qs + 2 * 192;
    const int pair = blockIdx.x, h = blockIdx.y, b = blockIdx.z;
    const int t0 = pair * 2, nk = (t0 / 64 + 1) * 64;
    const size_t rb = (size_t)b * Se;
    const float scale = rsqrtf((float)(NOPE + ROPE));
    for (int i = threadIdx.x; i < 2 * 192; i += blockDim.x) { const int qi = i / 192, d = i % 192; qs[i] = q[(rb + t0 + qi) * QW + h * 192 + d]; }
    __syncthreads();
    float mx0 = -3.0e38f, mx1 = -3.0e38f;
    for (int k = threadIdx.x; k < nk; k += blockDim.x) {
        const float* kn = kv + (rb + k) * KVW + h * 256; const float* kp = kr + (rb + k) * ROPE;
        float s0 = 0.f, s1 = 0.f;
        for (int d = 0; d < NOPE; ++d) { const float kvv = kn[d]; s0 += qs[d] * kvv; s1 += qs[192 + d] * kvv; }
        for (int d = 0; d < ROPE; ++d) { const float kvv = kp[d]; s0 += qs[NOPE + d] * kvv; s1 += qs[192 + NOPE + d] * kvv; }
        s0 *= scale; s1 *= scale; sc[k] = s0; sc[Se + k] = s1; mx0 = fmaxf(mx0, s0); mx1 = fmaxf(mx1, s1);
    }
    for (int o = 32; o > 0; o >>= 1) { mx0 = fmaxf(mx0, __shfl_xor(mx0, o)); mx1 = fmaxf(mx1, __shfl_xor(mx1, o)); }
    __syncthreads();
    if ((threadIdx.x & 63) == 0) { red[threadIdx.x >> 6] = mx0; red[4 + (threadIdx.x >> 6)] = mx1; }
    __syncthreads();
    mx0 = fmaxf(fmaxf(red[0], red[1]), fmaxf(red[2], red[3])); mx1 = fmaxf(fmaxf(red[4], red[5]), fmaxf(red[6], red[7]));
    float l0 = 0.f, l1 = 0.f;
    for (int k = threadIdx.x; k < nk; k += blockDim.x) { const float p0 = __expf(sc[k] - mx0), p1 = __expf(sc[Se + k] - mx1); sc[k] = p0; sc[Se + k] = p1; l0 += p0; l1 += p1; }
    for (int o = 32; o > 0; o >>= 1) { l0 += __shfl_xor(l0, o); l1 += __shfl_xor(l1, o); }
    __syncthreads();
    if ((threadIdx.x & 63) == 0) { red[threadIdx.x >> 6] = l0; red[4 + (threadIdx.x >> 6)] = l1; }
    __syncthreads();
    l0 = red[0] + red[1] + red[2] + red[3]; l1 = red[4] + red[5] + red[6] + red[7];
    const int qi = threadIdx.x >> 7, d = threadIdx.x & 127;
    const float* pr = sc + qi * Se; float o = 0.f;
    for (int k = 0; k < nk; ++k) o += pr[k] * kv[(rb + k) * KVW + h * 256 + NOPE + d];
    yb[(rb + t0 + qi) * (H * VH) + h * VH + d] = o / (qi ? l1 : l0);
}

__global__ void k_groupnorm(const float* __restrict__ ya, const float* __restrict__ yb, const float* __restrict__ g, float* __restrict__ ycat) {
    const int r = blockIdx.x, w = threadIdx.x >> 6, lane = threadIdx.x & 63;
    if (w < 8) { const float v = ya[(size_t)r * CW + w * 64 + lane]; float ss = v * v; for (int o = 32; o > 0; o >>= 1) ss += __shfl_xor(ss, o);
        ycat[(size_t)r * D + w * 64 + lane] = v * rsqrtf(ss / 64.f + EPS) * g[w * 64 + lane]; }
    else { const int hh = w - 8; const float v0 = yb[(size_t)r * 512 + hh * 128 + lane], v1 = yb[(size_t)r * 512 + hh * 128 + 64 + lane];
        float ss = v0 * v0 + v1 * v1; for (int o = 32; o > 0; o >>= 1) ss += __shfl_xor(ss, o);
        const float rs = rsqrtf(ss / 128.f + EPS);
        ycat[(size_t)r * D + 512 + hh * 128 + lane] = v0 * rs * g[512 + hh * 128 + lane];
        ycat[(size_t)r * D + 512 + hh * 128 + 64 + lane] = v1 * rs * g[512 + hh * 128 + 64 + lane]; }
}

static void naive_forward(void* const* d_in, float* xs, float* out, int ldo_rows_compact, unsigned char* ws, int Se, hipStream_t st) {
    const float* x = (const float*)d_in[0]; const float* c = (const float*)d_in[1]; const int* pos = (const int*)d_in[2];
    const float* ada_w = (const float*)d_in[3]; const float* ada_b = (const float*)d_in[4];
    const float* n1g = (const float*)d_in[5]; const float* f1w1 = (const float*)d_in[6]; const float* f1w3 = (const float*)d_in[7]; const float* f1w2 = (const float*)d_in[8];
    const float* nmg = (const float*)d_in[9]; const float* w_in = (const float*)d_in[10]; const float* conv_w = (const float*)d_in[11];
    const float* qng = (const float*)d_in[12]; const float* w_uq = (const float*)d_in[13]; const float* kvng = (const float*)d_in[14]; const float* w_ukv = (const float*)d_in[15];
    const float* ong = (const float*)d_in[16]; const float* w_out = (const float*)d_in[17];
    const float* n2g = (const float*)d_in[18]; const float* f2w1 = (const float*)d_in[19]; const float* f2w3 = (const float*)d_in[20]; const float* f2w2 = (const float*)d_in[21];
    const float* fng = (const float*)d_in[22];
    const int T = B * Se;
    const size_t MiB = 1u << 20; const double sc = (double)Se / S;
    auto off = [&](double mib) { return (size_t)(mib * sc * MiB + 255) & ~(size_t)255; };
    float* HB = (float*)(ws + off(0));
    float* U = (float*)(ws + off(64));
    float* ZC = (float*)(ws + off(64));
    float* CQ = (float*)(ws + off(160));
    float* CKV = (float*)(ws + off(184));
    float* KR = (float*)(ws + off(200));
    float* Q = (float*)(ws + off(204));
    float* MOD = (float*)(ws + off(252));
    int* POSC = (int*)(ws + off(253));
    float* KV = HB;
    float* YA = (float*)(ws + off(160));
    float* YB = (float*)(ws + off(64));
    float* YC = (float*)(ws + off(96));
    if (Se < S) { MOD = (float*)(ws + off(252)); POSC = (int*)((unsigned char*)MOD + 128 * 1024); }

    k_mod<<<dim3(NMOD * D / 256, B), 256, 0, st>>>(c, ada_w, ada_b, MOD);
    k_copy_rows<<<T, 256, 0, st>>>(x, xs, pos, POSC, Se);
    k_rmsnorm_rows<<<T, 256, 0, st>>>(xs, D, HB, D, n1g, D, MOD, 0, 1, Se);
    k_gemm<1><<<dim3(FF / 64, T / 64), 256, 0, st>>>(HB, D, f1w1, f1w3, FF, U, FF, D, nullptr, 0, nullptr, Se, 0.f);
    k_gemm<2><<<dim3(D / 64, T / 64), 256, 0, st>>>(U, FF, f1w2, nullptr, D, xs, D, FF, xs, D, MOD + 2 * D, Se, 0.5f);
    k_rmsnorm_rows<<<T, 256, 0, st>>>(xs, D, HB, D, nmg, D, MOD, 3, 4, Se);
    k_gemm<0><<<dim3(3 * CW / 64, T / 64), 256, 0, st>>>(HB, D, w_in, nullptr, INC, ZC, 3 * CW, D, nullptr, 0, nullptr, Se, 0.f);
    k_gemm<0><<<dim3(QL / 64, T / 64), 256, 0, st>>>(HB, D, w_in + 3 * CW, nullptr, INC, CQ, QL, D, nullptr, 0, nullptr, Se, 0.f);
    k_gemm<0><<<dim3(KVL / 64, T / 64), 256, 0, st>>>(HB, D, w_in + 3 * CW + QL, nullptr, INC, CKV, KVL, D, nullptr, 0, nullptr, Se, 0.f);
    k_gemm<0><<<dim3(ROPE / 64, T / 64), 256, 0, st>>>(HB, D, w_in + 3 * CW + QL + KVL, nullptr, INC, KR, ROPE, D, nullptr, 0, nullptr, Se, 0.f);
    k_rmsnorm_rows<<<T, 256, 0, st>>>(CQ, QL, CQ, QL, qng, QL, nullptr, -1, -1, Se);
    k_rmsnorm_rows<<<T, 256, 0, st>>>(CKV, KVL, CKV, KVL, kvng, KVL, nullptr, -1, -1, Se);
    k_gemm<0><<<dim3(QW / 64, T / 64), 256, 0, st>>>(CQ, QL, w_uq, nullptr, QW, Q, QW, QL, nullptr, 0, nullptr, Se, 0.f);
    k_gemm<0><<<dim3(KVW / 64, T / 64), 256, 0, st>>>(CKV, KVL, w_ukv, nullptr, KVW, KV, KVW, KVL, nullptr, 0, nullptr, Se, 0.f);
    k_rope<<<T, 256, 0, st>>>(Q, KR, POSC);
    k_conv<<<T, 256, 0, st>>>(ZC, conv_w, YA, Se);
    k_attn<<<dim3(Se / 2, H, B), 256, (2 * Se + 2 * 192 + 8) * sizeof(float), st>>>(Q, KV, KR, YB, Se);
    k_groupnorm<<<T, 64 * 12, 0, st>>>(YA, YB, ong, YC);
    k_gemm<2><<<dim3(D / 64, T / 64), 256, 0, st>>>(YC, D, w_out, nullptr, D, xs, D, D, xs, D, MOD + 5 * D, Se, 1.0f);
    k_rmsnorm_rows<<<T, 256, 0, st>>>(xs, D, HB, D, n2g, D, MOD, 6, 7, Se);
    k_gemm<1><<<dim3(FF / 64, T / 64), 256, 0, st>>>(HB, D, f2w1, f2w3, FF, U, FF, D, nullptr, 0, nullptr, Se, 0.f);
    k_gemm<2><<<dim3(D / 64, T / 64), 256, 0, st>>>(U, FF, f2w2, nullptr, D, xs, D, FF, xs, D, MOD + 8 * D, Se, 0.5f);
    k_rmsnorm_rows<<<T, 256, 0, st>>>(xs, D, out, D, fng, D, nullptr, -1, -1, Se);
    (void)ldo_rows_compact;
}
}

extern "C" void kernel_launch(void* const* d_in, const int* in_sizes, int n_in, void* d_out, int out_size, void* d_ws, size_t ws_size, hipStream_t stream) {
    static bool once = false;
    if (!once) { once = true;
        hipFuncSetAttribute((const void*)nv::k_attn, hipFuncAttributeMaxDynamicSharedMemorySize, (2 * nv::S + 2 * 192 + 8) * sizeof(float)); }
    nv::naive_forward(d_in, (float*)d_out, (float*)d_out, 0, (unsigned char*)d_ws, nv::S, stream);
}
```
